# Optimizing an MI355X kernel written in HIP

```python
import jax, jax.numpy as jnp
from jax import lax
import numpy as np

D_MODEL = 1024
BATCH = 2
SEQ = 8192
DEPTH = 2

D_MIX = D_MODEL
D_GMLP = D_MIX // 2
D_CONV = D_MIX - D_GMLP
GMLP_HEADS = 4
GMLP_HEAD_DIM = D_GMLP // GMLP_HEADS
CHUNK = 128
CONV_WIDTH = 31
CONV_GROUPS = 4
D_IN = 2 * D_GMLP + 2 * D_CONV
N_EXPERTS = 16
N_EXPERT_GROUPS = 4
EXPERTS_PER_GROUP = N_EXPERTS // N_EXPERT_GROUPS
TOP_K = 2
D_EXPERT = D_MODEL // 2
DEEPNORM_ALPHA = (2.0 * DEPTH) ** 0.25
DEEPNORM_BETA = (8.0 * DEPTH) ** -0.25
LN_EPS = 1e-5

kernel_name = "hybrid_gmlp_conformer_grouped_moe_deepnorm"


def _normalize(x):
    xf = x.astype(jnp.float32)
    mu = jnp.mean(xf, axis=-1, keepdims=True)
    var = jnp.mean(jnp.square(xf - mu), axis=-1, keepdims=True)
    return (xf - mu) * lax.rsqrt(var + LN_EPS)


def layer_norm(x, g, b):
    y = _normalize(x) * g.astype(jnp.float32) + b.astype(jnp.float32)
    return y.astype(x.dtype)


def gmlp_spatial_gating(u, v, v_ln_g, v_ln_b, w_s, b_s):
    B, S, _ = v.shape
    n_chunks = S // CHUNK
    vh = _normalize(v.reshape(B, S, GMLP_HEADS, GMLP_HEAD_DIM))
    vh = vh * v_ln_g.reshape(GMLP_HEADS, GMLP_HEAD_DIM).astype(jnp.float32) \
        + v_ln_b.reshape(GMLP_HEADS, GMLP_HEAD_DIM).astype(jnp.float32)
    vh = vh.astype(v.dtype).reshape(B, n_chunks, CHUNK, GMLP_HEADS, GMLP_HEAD_DIM)
    causal = jnp.tril(jnp.ones((CHUNK, CHUNK), dtype=bool))
    w = jnp.where(causal[None], w_s, jnp.zeros_like(w_s)).astype(v.dtype)
    mixed = jnp.einsum('hij,bnjhd->bnihd', w, vh) \
        + b_s.T.astype(v.dtype)[None, None, :, :, None]
    return u * mixed.reshape(B, S, D_GMLP)


def conformer_conv(a, g, conv_w, conv_b, gn_g, gn_b):
    h = a * jax.nn.sigmoid(g)
    B, S, C = h.shape
    h = lax.conv_general_dilated(
        h, conv_w[:, None, :].astype(h.dtype), window_strides=(1,),
        padding=[(CONV_WIDTH - 1, 0)], dimension_numbers=('NWC', 'WIO', 'NWC'),
        feature_group_count=C) + conv_b.astype(h.dtype)
    hn = _normalize(h.reshape(B, S, CONV_GROUPS, C // CONV_GROUPS)).reshape(B, S, C)
    hn = (hn * gn_g.astype(jnp.float32) + gn_b.astype(jnp.float32)).astype(h.dtype)
    return jax.nn.silu(hn)


def hybrid_mixer(x, w_in, b_in, v_ln_g, v_ln_b, w_s, b_s, conv_w, conv_b, gn_g, gn_b,
                 w_out, b_out):
    z = jnp.einsum('bsd,df->bsf', x, w_in) + b_in
    u, v, a, g = jnp.split(z, [D_GMLP, 2 * D_GMLP, 2 * D_GMLP + D_CONV], axis=-1)
    y_a = gmlp_spatial_gating(jax.nn.gelu(u), jax.nn.gelu(v), v_ln_g, v_ln_b, w_s, b_s)
    y_b = conformer_conv(a, g, conv_w, conv_b, gn_g, gn_b)
    y = jnp.concatenate([y_a, y_b], axis=-1)
    return jnp.einsum('bsf,fd->bsd', y, w_out) + b_out


def grouped_moe(x, w_router, router_bias, w_gate, w_up, w_down):
    B, S, D = x.shape
    t = x.reshape(B * S, D)
    T = t.shape[0]
    logits = t.astype(jnp.float32) @ w_router.astype(jnp.float32)
    scores = jax.nn.softmax(logits, axis=-1)
    sel = (scores + router_bias.astype(jnp.float32)).reshape(T, N_EXPERT_GROUPS, EXPERTS_PER_GROUP)
    group_score = lax.top_k(sel, TOP_K)[0].sum(-1)
    group = jnp.argmax(group_score, axis=-1)
    in_group = jnp.take_along_axis(sel, group[:, None, None], axis=1)[:, 0]
    _, local = lax.top_k(in_group, TOP_K)
    expert = group[:, None] * EXPERTS_PER_GROUP + local
    gate = jnp.take_along_axis(scores, expert, axis=-1)
    gate = gate / jnp.sum(gate, axis=-1, keepdims=True)
    combine = jnp.einsum('tk,tke->te', gate,
                         jax.nn.one_hot(expert, N_EXPERTS, dtype=jnp.float32)).astype(x.dtype)
    h = jax.nn.silu(jnp.einsum('td,edf->tef', t, w_gate)) * jnp.einsum('td,edf->tef', t, w_up)
    h = h * combine[:, :, None]
    out = jnp.einsum('tef,efd->td', h, w_down)
    return out.reshape(B, S, D)


def setup_inputs(seed: int = 0) -> dict:
    key = jax.random.key(seed)
    ks = jax.random.split(key, 24)
    f32 = jnp.float32

    def nrm(k, shape, scale):
        return jax.random.normal(k, shape, f32) * scale

    return {
        "x": jax.random.normal(ks[0], (BATCH, SEQ, D_MODEL), f32),
        "w_in": nrm(ks[1], (DEPTH, D_MODEL, D_IN), D_MODEL ** -0.5),
        "b_in": nrm(ks[2], (DEPTH, D_IN), 0.02),
        "v_ln_g": 1.0 + nrm(ks[3], (DEPTH, D_GMLP), 0.05),
        "v_ln_b": nrm(ks[4], (DEPTH, D_GMLP), 0.02),
        "w_spatial": nrm(ks[5], (DEPTH, GMLP_HEADS, CHUNK, CHUNK), CHUNK ** -0.5),
        "b_spatial": 1.0 + nrm(ks[6], (DEPTH, GMLP_HEADS, CHUNK), 0.1),
        "conv_w": nrm(ks[7], (DEPTH, CONV_WIDTH, D_CONV), CONV_WIDTH ** -0.5),
        "conv_b": nrm(ks[8], (DEPTH, D_CONV), 0.02),
        "gn_g": 1.0 + nrm(ks[9], (DEPTH, D_CONV), 0.05),
        "gn_b": nrm(ks[10], (DEPTH, D_CONV), 0.02),
        "w_out": nrm(ks[11], (DEPTH, D_MIX, D_MODEL), DEEPNORM_BETA * D_MIX ** -0.5),
        "b_out": nrm(ks[12], (DEPTH, D_MODEL), 0.02),
        "ln1_g": 1.0 + nrm(ks[13], (DEPTH, D_MODEL), 0.05),
        "ln1_b": nrm(ks[14], (DEPTH, D_MODEL), 0.02),
        "w_router": nrm(ks[15], (D_MODEL, N_EXPERTS), D_MODEL ** -0.5),
        "router_bias": nrm(ks[16], (N_EXPERTS,), 0.01),
        "w_gate": nrm(ks[17], (DEPTH, N_EXPERTS, D_MODEL, D_EXPERT), D_MODEL ** -0.5),
        "w_up": nrm(ks[18], (DEPTH, N_EXPERTS, D_MODEL, D_EXPERT), D_MODEL ** -0.5),
        "w_down": nrm(ks[19], (DEPTH, N_EXPERTS, D_EXPERT, D_MODEL), DEEPNORM_BETA * D_EXPERT ** -0.5),
        "ln2_g": 1.0 + nrm(ks[20], (DEPTH, D_MODEL), 0.05),
        "ln2_b": nrm(ks[21], (DEPTH, D_MODEL), 0.02),
    }


def reference(x, w_in, b_in, v_ln_g, v_ln_b, w_spatial, b_spatial, conv_w, conv_b, gn_g, gn_b,
              w_out, b_out, ln1_g, ln1_b, w_router, router_bias, w_gate, w_up, w_down,
              ln2_g, ln2_b):
    for l in range(DEPTH):
        mix = hybrid_mixer(x, w_in[l], b_in[l], v_ln_g[l], v_ln_b[l], w_spatial[l], b_spatial[l],
                           conv_w[l], conv_b[l], gn_g[l], gn_b[l], w_out[l], b_out[l])
        x = layer_norm(DEEPNORM_ALPHA * x + mix, ln1_g[l], ln1_b[l])
        ffn = grouped_moe(x, w_router, router_bias, w_gate[l], w_up[l], w_down[l])
        x = layer_norm(DEEPNORM_ALPHA * x + ffn, ln2_g[l], ln2_b[l])
    return x
```

```cpp
#include <hip/hip_runtime.h>
#include <cstdio>
#include <cstdint>

#ifndef MK_N_LAUNCHES
#define MK_N_LAUNCHES 1
#endif

#define LAS __attribute__((address_space(3)))
#define GAS __attribute__((address_space(1)))
typedef unsigned short bf16_t;
typedef short bf16x8 __attribute__((ext_vector_type(8)));
typedef float f32x4 __attribute__((ext_vector_type(4)));
typedef float f32x2 __attribute__((ext_vector_type(2)));
typedef unsigned u32x4 __attribute__((ext_vector_type(4)));
typedef unsigned u32x2 __attribute__((ext_vector_type(2)));

constexpr int SEQ = 8192, DM = 1024, M = 16384, DIN = 2048, NE = 16, DE = 512, DEPTH = 2, CW = 31;
constexpr float ALPHA = 1.41421356237309515f;
constexpr float LN_EPS = 1e-5f;
constexpr int NWAVES = 8;
constexpr int N_PHASES = 1 + 7 * DEPTH;

constexpr size_t MiB = 1u << 20;
constexpr size_t WS_CTL = 0, CTL_ZERO_BYTES = 1 * MiB;
constexpr size_t WS_LTOK = 1 * MiB;
constexpr size_t WS_LGATE = 2 * MiB;
constexpr size_t WS_BIN = 3 * MiB;
constexpr size_t WS_WIN = 4 * MiB;
constexpr size_t WS_WOUT = 12 * MiB;
constexpr size_t WS_WGU = 16 * MiB;
constexpr size_t WS_WD = 80 * MiB;
constexpr size_t WS_RA = 112 * MiB;
constexpr size_t WS_RB = 160 * MiB;
constexpr size_t WS_RC = 224 * MiB;
constexpr size_t WS_END = 256 * MiB;
constexpr int CW_TMO = 0;
constexpr int CW_BAR = 4096;
constexpr int CW_CNT = 16384;

constexpr int RING_BYTES = 131072;
constexpr int TAB_OFF = RING_BYTES;
constexpr int TAB_TOK = TAB_OFF, TAB_GW = TAB_OFF + 3072;
constexpr int META_OFF = TAB_OFF + 6144;
constexpr int MISC_OFF = META_OFF + 256;
constexpr int LDS_BYTES = 147456;

#define RLX_AGENT __ATOMIC_RELAXED, __HIP_MEMORY_SCOPE_AGENT
#define LDS_WAIT() asm volatile("s_waitcnt lgkmcnt(0)" ::: "memory")
#define VM_WAIT() asm volatile("s_waitcnt vmcnt(0)" ::: "memory")

__device__ __forceinline__ unsigned cvt_pk_bf16(float lo, float hi) { unsigned r; asm volatile("v_cvt_pk_bf16_f32 %0, %1, %2" : "=v"(r) : "v"(lo), "v"(hi)); return r; }
__device__ __forceinline__ float bf_lo(unsigned w) { return __uint_as_float(w << 16); }
__device__ __forceinline__ float bf_hi(unsigned w) { return __uint_as_float(w & 0xffff0000u); }
__device__ __forceinline__ float gelu_tanh(float x) {
    const float e = __builtin_amdgcn_exp2f(x * (-2.302208198f + -0.1029432397f * x * x));
    return x * __builtin_amdgcn_rcpf(1.0f + e);
}
__device__ __forceinline__ float sigmoid_f(float x) { return __builtin_amdgcn_rcpf(1.0f + __builtin_amdgcn_exp2f(-1.44269504089f * x)); }
__device__ __forceinline__ float wave_sum(float v) {
#pragma unroll
    for (int o = 1; o < 64; o <<= 1) v += __shfl_xor(v, o);
    return v;
}

namespace pg8 {
constexpr int BM = 256, BK = 64, HALF = 128, HTB = HALF * BK * 2, STAGE_BYTES = 8 * HTB, NXCD = 8, WGM = 8;
__host__ __device__ __forceinline__ int lds_byte(int r, int c) { const int st = (r >> 4) * 2 + (c >> 5), rr = r & 15, cc = c & 31, ob = rr * 64 + cc * 2; return st * 1024 + (ob ^ (((ob >> 9) & 1) << 5)); }
__host__ __device__ __forceinline__ void stage_rc(int b, int& R, int& C) { const int st = b / 1024, sb = b % 1024, swz = sb ^ (((sb >> 9) & 1) << 5); R = (st >> 1) * 16 + swz / 64; C = (st & 1) * 32 + (swz % 64) / 2; }
__host__ __device__ __forceinline__ int perm32(int rho) { const int n = rho >> 4, i = rho & 15; return 8 * (i >> 2) + 4 * n + (i & 3); }

struct Unit { int pm, pn, bn, ui, cnt; };
struct Gemm { const bf16_t* A; const bf16_t* Bt; int K; };

struct StaticOrder {
    int nM, nN, nwg, G, c;
    __device__ void init(int M_, int N_, int G_, int c_) { nM = M_ / BM; nN = N_ / BM; nwg = nM * nN; G = G_; c = c_; }
    __device__ __forceinline__ bool next(int i, Unit& u) const {
        const long L = (long)i * G + c; if (L >= nwg) return false;
        int wgid = (int)L; { const int q = nwg / NXCD, r = nwg % NXCD, xcd = wgid % NXCD, off = wgid / NXCD; wgid = (xcd < r ? xcd * (q + 1) : r * (q + 1) + (xcd - r) * q) + off; }
        const int nig = WGM * nN, gid = wgid / nig, fm = gid * WGM, gsz = (nM - fm) < WGM ? (nM - fm) : WGM;
        u.pm = fm + ((wgid % nig) % gsz); u.pn = (wgid % nig) / gsz; u.bn = u.pn; u.ui = i; u.cnt = 256; return true;
    }
    static constexpr bool GATHER = false;
    __device__ __forceinline__ int a_row(const Unit& u, int r) const { return u.pm * BM + r; }
};
template <bool GATHER_> struct MoeOrder {
    static constexpr bool GATHER = GATHER_;
    const LAS int* meta; const LAS int* tok;
    __device__ __forceinline__ bool next(int i, Unit& u) const {
        if (i >= __builtin_amdgcn_readfirstlane(meta[36])) return false;
        u.pm = __builtin_amdgcn_readfirstlane(meta[40 + 4 * i]); u.pn = __builtin_amdgcn_readfirstlane(meta[41 + 4 * i]);
        u.bn = __builtin_amdgcn_readfirstlane(meta[42 + 4 * i]); u.cnt = __builtin_amdgcn_readfirstlane(meta[43 + 4 * i]); u.ui = i; return true;
    }
    __device__ __forceinline__ int a_row(const Unit& u, int r) const { if (GATHER) return tok[u.ui * 256 + r] >> 1; return u.pm * BM + r; }
};

struct EpiInProj {
    static constexpr bool PERM = true;
    bf16_t* UV; bf16_t* H; const float* bias;
    __device__ __forceinline__ void operator()(const f32x4 (&acc)[2][2][4][2], const Unit& u, int wr, int wc, int fr, int fq) const {
        const int row0 = u.pm * BM + wr * 64 + fr, cb = wc * 32 + 8 * fq;
        f32x4 bv[2][2];
#pragma unroll
        for (int bj = 0; bj < 2; ++bj)
#pragma unroll
            for (int n = 0; n < 2; ++n) bv[bj][n] = *(const f32x4*)(bias + u.pn * BM + bj * HALF + cb + 4 * n);
        if (u.pn < 4) {
#pragma unroll
            for (int ai = 0; ai < 2; ++ai)
#pragma unroll
                for (int m = 0; m < 4; ++m) { bf16_t* rowp = UV + (size_t)(row0 + ai * HALF + m * 16) * 1024 + u.pn * BM + cb;
#pragma unroll
                    for (int bj = 0; bj < 2; ++bj) { f32x4 v0 = acc[ai][bj][m][0] + bv[bj][0], v1 = acc[ai][bj][m][1] + bv[bj][1];
#pragma unroll
                        for (int j = 0; j < 4; ++j) { v0[j] = gelu_tanh(v0[j]); v1[j] = gelu_tanh(v1[j]); }
                        u32x4 w; w.x = cvt_pk_bf16(v0[0], v0[1]); w.y = cvt_pk_bf16(v0[2], v0[3]); w.z = cvt_pk_bf16(v1[0], v1[1]); w.w = cvt_pk_bf16(v1[2], v1[3]);
                        *(u32x4*)(rowp + bj * HALF) = w; } }
        } else {
#pragma unroll
            for (int ai = 0; ai < 2; ++ai)
#pragma unroll
                for (int m = 0; m < 4; ++m) { bf16_t* rowp = H + (size_t)(row0 + ai * HALF + m * 16) * 512 + (u.pn - 4) * HALF + cb;
                    f32x4 a0 = acc[ai][0][m][0] + bv[0][0], a1 = acc[ai][0][m][1] + bv[0][1], g0 = acc[ai][1][m][0] + bv[1][0], g1 = acc[ai][1][m][1] + bv[1][1];
#pragma unroll
                    for (int j = 0; j < 4; ++j) { a0[j] *= sigmoid_f(g0[j]); a1[j] *= sigmoid_f(g1[j]); }
                    u32x4 w; w.x = cvt_pk_bf16(a0[0], a0[1]); w.y = cvt_pk_bf16(a0[2], a0[3]); w.z = cvt_pk_bf16(a1[0], a1[1]); w.w = cvt_pk_bf16(a1[2], a1[3]);
                    *(u32x4*)rowp = w; }
        }
    }
};
struct EpiPre {
    static constexpr bool PERM = false;
    float* PRE; const float* res; const float* bias;
    __device__ __forceinline__ void operator()(const f32x4 (&acc)[2][2][4][2], const Unit& u, int wr, int wc, int fr, int fq) const {
        const int row0 = u.pm * BM + wr * 64 + fr, col0 = u.pn * BM + wc * 32 + 4 * fq;
        f32x4 bv[2][2];
#pragma unroll
        for (int bj = 0; bj < 2; ++bj)
#pragma unroll
            for (int n = 0; n < 2; ++n) bv[bj][n] = *(const f32x4*)(bias + col0 + bj * HALF + n * 16);
#pragma unroll
        for (int ai = 0; ai < 2; ++ai)
#pragma unroll
            for (int m = 0; m < 4; ++m) { const size_t off = (size_t)(row0 + ai * HALF + m * 16) * 1024 + col0;
#pragma unroll
                for (int bj = 0; bj < 2; ++bj)
#pragma unroll
                    for (int n = 0; n < 2; ++n) { const f32x4 r = *(const f32x4*)(res + off + bj * HALF + n * 16);
                        *(f32x4*)(PRE + off + bj * HALF + n * 16) = acc[ai][bj][m][n] + bv[bj][n] + r * ALPHA; } }
    }
};
struct EpiSwiGLU {
    static constexpr bool PERM = true;
    bf16_t* Hs; const LAS float* gw;
    __device__ __forceinline__ void operator()(const f32x4 (&acc)[2][2][4][2], const Unit& u, int wr, int wc, int fr, int fq) const {
        const int cb = wc * 32 + 8 * fq;
#pragma unroll
        for (int ai = 0; ai < 2; ++ai)
#pragma unroll
            for (int m = 0; m < 4; ++m) { const int r = ai * HALF + wr * 64 + m * 16 + fr; const float g = gw[u.ui * 256 + r];
                bf16_t* rowp = Hs + (size_t)(u.pm * BM + r) * 512 + u.pn * HALF + cb;
                f32x4 a0 = acc[ai][0][m][0], a1 = acc[ai][0][m][1]; const f32x4 u0 = acc[ai][1][m][0], u1 = acc[ai][1][m][1];
#pragma unroll
                for (int j = 0; j < 4; ++j) { a0[j] = a0[j] * sigmoid_f(a0[j]) * u0[j] * g; a1[j] = a1[j] * sigmoid_f(a1[j]) * u1[j] * g; }
                u32x4 w; w.x = cvt_pk_bf16(a0[0], a0[1]); w.y = cvt_pk_bf16(a0[2], a0[3]); w.z = cvt_pk_bf16(a1[0], a1[1]); w.w = cvt_pk_bf16(a1[2], a1[3]);
                *(u32x4*)rowp = w; asm volatile("" ::: "memory"); }
    }
};
struct EpiScatter {
    static constexpr bool PERM = true;
    bf16_t* YM; const LAS int* tok;
    __device__ __forceinline__ void operator()(const f32x4 (&acc)[2][2][4][2], const Unit& u, int wr, int wc, int fr, int fq) const {
        const int cb = wc * 32 + 8 * fq;
#pragma unroll
        for (int ai = 0; ai < 2; ++ai)
#pragma unroll
            for (int m = 0; m < 4; ++m) { const int r = ai * HALF + wr * 64 + m * 16 + fr;
                if (r < u.cnt) { const int en = tok[u.ui * 256 + r];
                    bf16_t* rowp = YM + ((size_t)(en & 1) * M + (size_t)(en >> 1)) * 1024 + u.pn * BM + cb;
#pragma unroll
                    for (int bj = 0; bj < 2; ++bj) { const f32x4 v0 = acc[ai][bj][m][0], v1 = acc[ai][bj][m][1];
                        u32x4 w; w.x = cvt_pk_bf16(v0[0], v0[1]); w.y = cvt_pk_bf16(v0[2], v0[3]); w.z = cvt_pk_bf16(v1[0], v1[1]); w.w = cvt_pk_bf16(v1[2], v1[3]);
                        *(u32x4*)(rowp + bj * HALF) = w; } }
                asm volatile("" ::: "memory"); }
    }
};

template <class Epi, class Sched, bool ALIGN_EPI>
__device__ __forceinline__ void gemm_phase(LAS unsigned char* lds, const Gemm g, const Sched& S, const Epi& E) {
    int tid_ = threadIdx.x; asm volatile("" : "+v"(tid_));
    const int tid = tid_, wid = __builtin_amdgcn_readfirstlane(tid >> 6), lane = tid & 63, wr = wid >> 2, wc = wid & 3, fr = lane & 15, fq = lane >> 4;
    const int K = g.K, nt = K / BK;
    unsigned voffB[2], voffA[2]; int sR0, sC0;
    { int R, C; stage_rc(tid * 16, R, C); sR0 = R; sC0 = C;
#pragma unroll
      for (int i = 0; i < 2; ++i) { const int Ri = R + 64 * i; const int Rb = Epi::PERM ? ((Ri & ~31) + perm32(Ri & 31)) : Ri; voffB[i] = (unsigned)(Rb * K + C) * 2u; voffA[i] = (unsigned)(Ri * K + C) * 2u; } }
    const size_t kstep = (size_t)(BK * 2);
    const size_t hstep = (size_t)HALF * K * 2;
    const size_t tstep = 2 * hstep;
    const unsigned ldsw = (unsigned)wid * 1024u;
    const int aoff = lds_byte(wr * 64 + fr, fq * 8), boff = lds_byte(wc * 32 + fr, fq * 8);
#define PG8_SA(b, h) (((b) * 2 + (h)) * HTB)
#define PG8_SB(b, h) ((4 + (b) * 2 + (h)) * HTB)
#define PG8_STAGE(bufoff, gbase, voff) do { _Pragma("unroll") for (int _i = 0; _i < 2; ++_i) \
        __builtin_amdgcn_global_load_lds((const unsigned*)((const char*)(gbase) + (voff)[_i]), (LAS unsigned*)(lds + (bufoff) + ldsw + _i * 8192), 16, 0, 0); } while (0)
#define PG8_LDA(dst, b, h) do { _Pragma("unroll") for (int m = 0; m < 4; ++m) _Pragma("unroll") for (int k = 0; k < 2; ++k) dst[m][k] = *(const LAS bf16x8*)(lds + PG8_SA(b, h) + aoff + m * 2048 + k * 1024); } while (0)
#define PG8_LDB(dst, b, h) do { _Pragma("unroll") for (int n = 0; n < 2; ++n) _Pragma("unroll") for (int k = 0; k < 2; ++k) dst[n][k] = *(const LAS bf16x8*)(lds + PG8_SB(b, h) + boff + n * 2048 + k * 1024); } while (0)
#define PG8_MMA(ai, bj, At, Bt) do { __builtin_amdgcn_s_setprio(1); _Pragma("unroll") for (int m = 0; m < 4; ++m) _Pragma("unroll") for (int n = 0; n < 2; ++n) _Pragma("unroll") for (int k = 0; k < 2; ++k) \
        acc[ai][bj][m][n] = __builtin_amdgcn_mfma_f32_16x16x32_bf16(Bt[n][k], At[m][k], acc[ai][bj][m][n], 0, 0, 0); __builtin_amdgcn_s_setprio(0); } while (0)
#define PG8_WAIT_V(n) asm volatile("s_waitcnt vmcnt(" #n ")" ::: "memory")
#define PG8_WAIT_L(n) asm volatile("s_waitcnt lgkmcnt(" #n ")" ::: "memory")
#define PG8_BAR __builtin_amdgcn_s_barrier()
#define PG8_SCHED __builtin_amdgcn_sched_barrier(0)
#define PG8_SETV(v, u) do { if constexpr (Sched::GATHER) { _Pragma("unroll") for (int _h = 0; _h < 2; ++_h) _Pragma("unroll") for (int _i = 0; _i < 2; ++_i) \
        v[_h][_i] = (unsigned)(S.a_row(u, _h * HALF + sR0 + 64 * _i) * K + sC0) * 2u; } } while (0)
#define PG8_STAGE_A(bufoff, h, koff, ubase, gv) do { if constexpr (Sched::GATHER) PG8_STAGE(bufoff, A0 + (koff), (gv)[h]); else PG8_STAGE(bufoff, (ubase) + (h) * hstep + (koff), voffA); } while (0)
    Unit cur, nxt; int ui = 0;
    if (!S.next(0, cur)) return;
    f32x4 acc[2][2][4][2];
#pragma unroll
    for (int a = 0; a < 2; ++a)
#pragma unroll
        for (int b = 0; b < 2; ++b)
#pragma unroll
            for (int m = 0; m < 4; ++m)
#pragma unroll
                for (int n = 0; n < 2; ++n) acc[a][b][m][n] = (f32x4){0.f, 0.f, 0.f, 0.f};
    bf16x8 At[4][2], B0[2][2], B1[2][2];
    unsigned cvA[2][2];
    PG8_SETV(cvA, cur);
    const char* A0 = (const char*)g.A; const char* cB = (const char*)g.Bt + (size_t)cur.bn * tstep;
    const char* cA = A0 + (size_t)(Sched::GATHER ? 0 : cur.pm) * tstep;
    PG8_STAGE(PG8_SB(0, 0), cB, voffB); PG8_STAGE(PG8_SB(0, 1), cB + hstep, voffB); PG8_STAGE_A(PG8_SA(0, 0), 0, 0, cA, cvA); PG8_STAGE_A(PG8_SA(0, 1), 1, 0, cA, cvA);
    if (wr == 1) PG8_BAR;
    PG8_WAIT_V(2); PG8_BAR;
    PG8_STAGE(PG8_SB(1, 0), cB + kstep, voffB); PG8_STAGE_A(PG8_SA(1, 0), 0, kstep, cA, cvA); PG8_STAGE(PG8_SB(1, 1), cB + hstep + kstep, voffB);
    PG8_WAIT_V(6); PG8_BAR;
    for (;;) {
        const bool has_next = S.next(ui + 1, nxt);
        const char* nB = has_next ? (const char*)g.Bt + (size_t)nxt.bn * tstep : cB;
        const char* nA = (has_next && !Sched::GATHER) ? A0 + (size_t)nxt.pm * tstep : cA;
        for (int t = 0; t < nt; t += 2) {
            const bool last = (t == nt - 2);
            const size_t k1 = (size_t)(t + 1) * kstep, k2 = last ? 0 : (size_t)(t + 2) * kstep, k3 = k2 + kstep;
            const char* u2 = last ? nA : cA;
            const char* b2 = last ? nB : cB + (size_t)(t + 2) * kstep; const char* b3 = b2 + kstep;
            unsigned v2[2][2];
            if constexpr (Sched::GATHER) { if (last && has_next) { PG8_SETV(v2, nxt); } else {
#pragma unroll
                for (int h = 0; h < 2; ++h)
#pragma unroll
                    for (int i = 0; i < 2; ++i) v2[h][i] = cvA[h][i]; } }
            PG8_LDB(B0, 0, 0); PG8_LDB(B1, 0, 1); PG8_SCHED; PG8_LDA(At, 0, 0); PG8_STAGE_A(PG8_SA(1, 1), 1, k1, cA, cvA);
            PG8_WAIT_V(8); PG8_WAIT_L(0); PG8_BAR; PG8_MMA(0, 0, At, B0); PG8_MMA(0, 1, At, B1); PG8_BAR; PG8_SCHED;
            PG8_LDA(At, 0, 1); PG8_STAGE(PG8_SB(0, 0), b2, voffB); PG8_STAGE(PG8_SB(0, 1), b2 + hstep, voffB); PG8_STAGE_A(PG8_SA(0, 0), 0, k2, u2, v2);
            PG8_WAIT_V(8); PG8_WAIT_L(0); PG8_BAR; PG8_MMA(1, 0, At, B0); PG8_MMA(1, 1, At, B1); PG8_BAR; PG8_SCHED;
            PG8_LDB(B0, 1, 0); PG8_LDB(B1, 1, 1); PG8_SCHED; PG8_LDA(At, 1, 0); PG8_STAGE_A(PG8_SA(0, 1), 1, k2, u2, v2);
            PG8_WAIT_V(8); PG8_WAIT_L(0); PG8_BAR; PG8_MMA(0, 0, At, B0); PG8_MMA(0, 1, At, B1); PG8_BAR; PG8_SCHED;
            PG8_LDA(At, 1, 1); PG8_STAGE(PG8_SB(1, 0), b3, voffB); PG8_STAGE(PG8_SB(1, 1), b3 + hstep, voffB); PG8_STAGE_A(PG8_SA(1, 0), 0, k3, u2, v2);
            PG8_WAIT_V(8); PG8_WAIT_L(0); PG8_BAR; PG8_MMA(1, 0, At, B0); PG8_MMA(1, 1, At, B1); PG8_BAR; PG8_SCHED;
        }
        if constexpr (ALIGN_EPI) { if (wr == 0) PG8_BAR; }
        E(acc, cur, wr, wc, fr, fq);
        if (!has_next) break;
#pragma unroll
        for (int a = 0; a < 2; ++a)
#pragma unroll
            for (int b = 0; b < 2; ++b)
#pragma unroll
                for (int m = 0; m < 4; ++m)
#pragma unroll
                    for (int n = 0; n < 2; ++n) acc[a][b][m][n] = (f32x4){0.f, 0.f, 0.f, 0.f};
        cur = nxt; cB = nB; cA = nA; ++ui;
        PG8_SETV(cvA, cur);
        if constexpr (ALIGN_EPI) { if (wr == 1) PG8_BAR; }
    }
    PG8_WAIT_V(0);
    if constexpr (!ALIGN_EPI) { if (wr == 0) PG8_BAR; }
    PG8_BAR;
#undef PG8_SA
#undef PG8_SB
#undef PG8_STAGE
#undef PG8_LDA
#undef PG8_LDB
#undef PG8_MMA
#undef PG8_WAIT_V
#undef PG8_WAIT_L
#undef PG8_BAR
#undef PG8_SCHED
#undef PG8_SETV
#undef PG8_STAGE_A
}
}

#define XB_TMO      128
#define XB_XCNT(j)  (256  + 64 * (j))
#define XB_XSUB(j)  (1280 + 64 * (j))
#define XB_XGEN(j)  (2304 + 64 * (j))
#define XB_TOP      3328
#define XB_TOPGEN   3392
#define XCD_BAR_WORDS 3456
#define XB_SPIN_CAP (1u << 18)
__device__ __forceinline__ unsigned xb_ld(unsigned* p)              { return __hip_atomic_load(p, __ATOMIC_RELAXED, __HIP_MEMORY_SCOPE_AGENT); }
__device__ __forceinline__ unsigned xb_add(unsigned* p, unsigned v) { return __hip_atomic_fetch_add(p, v, __ATOMIC_RELAXED, __HIP_MEMORY_SCOPE_AGENT); }
__device__ __forceinline__ unsigned xb_xcc_id() { return (unsigned)__builtin_amdgcn_s_getreg((3 << 11) | 20) & 0xFu; }
#define XB_SPIN(cond, bar) do { unsigned _sp = 0; while (cond) { __builtin_amdgcn_s_sleep(1); \
    if ((++_sp & 255u) == 0u) { if (xb_ld(&(bar)[XB_TMO])) break; if (_sp > XB_SPIN_CAP) { atomicAdd(&(bar)[XB_TMO], 1u); break; } } } } while (0)
struct XcdBarrier { unsigned* bar; unsigned x; volatile LAS unsigned* st; };
__device__ __forceinline__ XcdBarrier xcd_barrier_post(unsigned* bar, volatile LAS unsigned* st) {
    XcdBarrier b; b.bar = bar; b.x = xb_xcc_id(); b.st = st;
    if (threadIdx.x == 0) (void)xb_add(&bar[XB_XCNT(b.x)], 1u);
    return b;
}
__device__ __forceinline__ void xcd_barrier_complete(unsigned* bar, unsigned x, unsigned& nloc, unsigned& nx) {
    const unsigned G = gridDim.x * gridDim.y * gridDim.z;
    unsigned sum, cnt, mine, sp = 0u;
    for (;;) {
        sum = 0u; cnt = 0u; mine = 0u;
#pragma unroll
        for (unsigned j = 0; j < 16; ++j) { const unsigned c = xb_ld(&bar[XB_XCNT(j)]); sum += c; cnt += (c > 0u) ? 1u : 0u; mine = (j == x) ? c : mine; }
        if (sum == G) break;
        __builtin_amdgcn_s_sleep(1);
        if ((++sp & 255u) == 0u) { if (xb_ld(&bar[XB_TMO])) break; if (sp > XB_SPIN_CAP) { atomicAdd(&bar[XB_TMO], 1u); break; } }
    }
    nloc = mine > 0u ? mine : 1u; nx = cnt > 0u ? cnt : 1u;
}
__device__ __forceinline__ void xcd_barrier(const XcdBarrier& b) {
    asm volatile("s_waitcnt vmcnt(0)" ::: "memory");
    __syncthreads();
    if (threadIdx.x == 0) {
        unsigned* bar = b.bar;
        __builtin_amdgcn_s_waitcnt(0);
        unsigned nloc = b.st[0], nx = b.st[1];
        if (nloc == 0u) { xcd_barrier_complete(bar, b.x, nloc, nx); b.st[0] = nloc; b.st[1] = nx; }
        const unsigned old = xb_add(&bar[XB_XSUB(b.x)], 1u);
        const unsigned gen = old / nloc;
        if (old + 1u == (gen + 1u) * nloc) {
            __builtin_amdgcn_fence(__ATOMIC_RELEASE, "agent");
            asm volatile("s_waitcnt vmcnt(0)" ::: "memory");
            const unsigned og = xb_add(&bar[XB_TOP], 1u);
            const unsigned tg = og / nx;
            if (og + 1u == (tg + 1u) * nx) xb_add(&bar[XB_TOPGEN], 1u);
            else XB_SPIN(xb_ld(&bar[XB_TOPGEN]) == tg, bar);
            __builtin_amdgcn_fence(__ATOMIC_ACQUIRE, "agent");
            xb_add(&bar[XB_XGEN(b.x)], 1u);
            asm volatile("s_waitcnt vmcnt(0)" ::: "memory");
        } else {
            XB_SPIN(xb_ld(&bar[XB_XGEN(b.x)]) == gen, bar);
            __builtin_amdgcn_fence(__ATOMIC_ACQUIRE, "agent");
            asm volatile("s_waitcnt vmcnt(0)" ::: "memory");
        }
    }
    __syncthreads();
}

struct Args { const float* in[22]; float* out; unsigned char* ws; int ph_lo, ph_hi; };
struct Frame {
    LAS unsigned char* lds;
    unsigned* ctl;
    int tid, lane, wave, vcu, G;
    float* out; unsigned char* ws;
};

__device__ __forceinline__ void p0_transpose_item(const float* W, int ldn, int k0, int n0, bf16_t* WTrow0, int K, LAS float* scr, int lane) {
#pragma unroll 8
    for (int i = 0; i < 32; ++i) { const int kk = 2 * i + (lane >> 5); scr[kk * 33 + (lane & 31)] = W[(size_t)(k0 + kk) * ldn + n0 + (lane & 31)]; }
    LDS_WAIT(); asm volatile("" ::: "memory");
    const int c = lane & 7;
#pragma unroll
    for (int j = 0; j < 4; ++j) { const int n = (lane >> 3) + 8 * j; const LAS float* s = scr + (8 * c) * 33 + n;
        u32x4 o; o.x = cvt_pk_bf16(s[0 * 33], s[1 * 33]); o.y = cvt_pk_bf16(s[2 * 33], s[3 * 33]); o.z = cvt_pk_bf16(s[4 * 33], s[5 * 33]); o.w = cvt_pk_bf16(s[6 * 33], s[7 * 33]);
        *(u32x4*)(WTrow0 + (size_t)n * K + k0 + 8 * c) = o; }
    LDS_WAIT(); asm volatile("" ::: "memory");
}
__device__ __forceinline__ int inproj_rowmap(int n) {
    if (n < 1024) return n;
    if (n < 1536) { const int c = n - 1024; return 1024 + (c >> 7) * 256 + (c & 127); }
    const int c = n - 1536; return 1024 + (c >> 7) * 256 + 128 + (c & 127);
}
__device__ __forceinline__ void p0_prologue(Frame& F, const Args& A) {
    LAS float* scr = (LAS float*)(F.lds + F.wave * 16384);
    const int gw = F.vcu * NWAVES + F.wave, NGW = F.G * NWAVES;
    bf16_t* WIN = (bf16_t*)(F.ws + WS_WIN); bf16_t* WOUT = (bf16_t*)(F.ws + WS_WOUT); bf16_t* WGU = (bf16_t*)(F.ws + WS_WGU); bf16_t* WD = (bf16_t*)(F.ws + WS_WD);
    constexpr int I_IN = DEPTH * 16 * 64, I_OUT = DEPTH * 16 * 32, I_G = DEPTH * NE * 16 * 16, I_D = DEPTH * NE * 8 * 32;
    constexpr int NITEMS = I_IN + I_OUT + 2 * I_G + I_D;
    for (int it = gw; it < NITEMS; it += NGW) {
        int r = it;
        if (r < I_IN) { const int l = r / 1024, q = r % 1024, kb = q / 64, nb = q % 64;
            p0_transpose_item(A.in[1] + (size_t)l * DM * DIN, DIN, 64 * kb, 32 * nb, WIN + ((size_t)l * DIN + inproj_rowmap(32 * nb)) * DM, DM, scr, F.lane); continue; } r -= I_IN;
        if (r < I_OUT) { const int l = r / 512, q = r % 512, kb = q / 32, nb = q % 32;
            p0_transpose_item(A.in[11] + (size_t)l * DM * DM, DM, 64 * kb, 32 * nb, WOUT + ((size_t)l * DM + 32 * nb) * DM, DM, scr, F.lane); continue; } r -= I_OUT;
        if (r < 2 * I_G) { const int up = r / I_G; const int q0 = r % I_G; const int le = q0 / 256, q = q0 % 256, kb = q / 16, nb = q % 16; const int f = 32 * nb;
            p0_transpose_item((up ? A.in[18] : A.in[17]) + (size_t)le * DM * DE, DE, 64 * kb, f, WGU + ((size_t)le * 1024 + (f >> 7) * 256 + up * 128 + (f & 127)) * DM, DM, scr, F.lane); continue; } r -= 2 * I_G;
        { const int le = r / 256, q = r % 256, kb = q / 32, nb = q % 32;
            p0_transpose_item(A.in[19] + (size_t)le * DE * DM, DM, 64 * kb, 32 * nb, WD + ((size_t)le * 1024 + 32 * nb) * DE, DE, scr, F.lane); }
    }
    { bf16_t* XB = (bf16_t*)(F.ws + WS_RC); const float* x = A.in[0];
      for (int m = gw; m < M; m += NGW) { const f32x4* xr = (const f32x4*)(x + (size_t)m * DM) + F.lane; u32x2* o = (u32x2*)(XB + (size_t)m * DM) + F.lane;
#pragma unroll
          for (int j = 0; j < 4; ++j) { const f32x4 v = xr[64 * j]; u32x2 w; w.x = cvt_pk_bf16(v[0], v[1]); w.y = cvt_pk_bf16(v[2], v[3]); o[64 * j] = w; } } }
    { float* BIN = (float*)(F.ws + WS_BIN); const int gt = (F.vcu * NWAVES + F.wave) * 64 + F.lane;
      if (gt < DEPTH * DIN) { const int l = gt / DIN, n = gt % DIN; BIN[l * DIN + inproj_rowmap(n)] = A.in[2][gt]; } }
}

__device__ __forceinline__ void p2_gmlp_unit(Frame& F, const Args& A, int l, int q) {
    const int h = q & 3, n = (q >> 2) & 63, b = q >> 8, row0 = b * SEQ + n * 128;
    const bf16_t* UV = (const bf16_t*)(F.ws + WS_RA); bf16_t* Y = (bf16_t*)(F.ws + WS_RC);
    LAS unsigned char* WSL = F.lds; LAS unsigned char* VTL = F.lds + 34816;
    { const float* Ws = A.in[5] + ((size_t)(l * 4 + h) * 128) * 128; const int i = F.tid >> 2, jq = F.tid & 3;
#pragma unroll
      for (int k = 0; k < 8; ++k) { const int j = 32 * jq + 4 * k; f32x4 w = *(const f32x4*)(Ws + (size_t)i * 128 + j);
#pragma unroll
          for (int c = 0; c < 4; ++c) w[c] = (j + c <= i) ? w[c] : 0.f;
          u32x2 o; o.x = cvt_pk_bf16(w[0], w[1]); o.y = cvt_pk_bf16(w[2], w[3]); *(LAS u32x2*)(WSL + i * 272 + j * 2) = o; } }
    { const int c8 = (F.tid & 15) * 8; const float* lg = A.in[3] + l * 512 + h * 128 + c8; const float* lb = A.in[4] + l * 512 + h * 128 + c8;
      const f32x4 g0 = *(const f32x4*)lg, g1 = *(const f32x4*)(lg + 4), b0 = *(const f32x4*)lb, b1 = *(const f32x4*)(lb + 4);
#pragma unroll
      for (int p = 0; p < 4; ++p) { const int r = (F.tid >> 4) + 32 * p;
          const u32x4 raw = *(const u32x4*)(UV + (size_t)(row0 + r) * 1024 + 512 + h * 128 + c8);
          float v[8]; v[0] = bf_lo(raw.x); v[1] = bf_hi(raw.x); v[2] = bf_lo(raw.y); v[3] = bf_hi(raw.y); v[4] = bf_lo(raw.z); v[5] = bf_hi(raw.z); v[6] = bf_lo(raw.w); v[7] = bf_hi(raw.w);
          float s = ((v[0] + v[1]) + (v[2] + v[3])) + ((v[4] + v[5]) + (v[6] + v[7]));
          s += __shfl_xor(s, 1); s += __shfl_xor(s, 2); s += __shfl_xor(s, 4); s += __shfl_xor(s, 8);
          const float mean = s * (1.f / 128.f); float q2 = 0.f;
#pragma unroll
          for (int k = 0; k < 8; ++k) { v[k] -= mean; q2 += v[k] * v[k]; }
          q2 += __shfl_xor(q2, 1); q2 += __shfl_xor(q2, 2); q2 += __shfl_xor(q2, 4); q2 += __shfl_xor(q2, 8);
          const float rstd = 1.0f / sqrtf(q2 * (1.f / 128.f) + LN_EPS);
#pragma unroll
          for (int k = 0; k < 8; ++k) { const float gk = k < 4 ? g0[k & 3] : g1[k & 3], bk = k < 4 ? b0[k & 3] : b1[k & 3];
              const float o = v[k] * rstd * gk + bk; *(LAS bf16_t*)(VTL + (c8 + k) * 272 + r * 2) = (bf16_t)(cvt_pk_bf16(o, 0.f) & 0xffffu); } } }
    LDS_WAIT(); __syncthreads();
    { const int i0 = 16 * F.wave, fr = F.lane & 15, fq = F.lane >> 4; const int nks = (i0 + 15) / 32 + 1;
      f32x4 acc[8];
#pragma unroll
      for (int d = 0; d < 8; ++d) acc[d] = (f32x4){0.f, 0.f, 0.f, 0.f};
      for (int ks = 0; ks < nks; ++ks) {
          const bf16x8 wf = *(const LAS bf16x8*)(WSL + (i0 + fr) * 272 + (32 * ks + 8 * fq) * 2);
#pragma unroll
          for (int d = 0; d < 8; ++d) { const bf16x8 vf = *(const LAS bf16x8*)(VTL + (16 * d + fr) * 272 + (32 * ks + 8 * fq) * 2);
              acc[d] = __builtin_amdgcn_mfma_f32_16x16x32_bf16(vf, wf, acc[d], 0, 0, 0); } }
      const float bsv = A.in[6][(l * 4 + h) * 128 + i0 + fr];
      const size_t rbase = (size_t)(row0 + i0 + fr) * 1024 + h * 128 + 4 * fq;
#pragma unroll
      for (int d = 0; d < 8; ++d) { const u32x2 uu = *(const u32x2*)(UV + rbase + 16 * d);
          const float y0 = bf_lo(uu.x) * (acc[d][0] + bsv), y1 = bf_hi(uu.x) * (acc[d][1] + bsv), y2 = bf_lo(uu.y) * (acc[d][2] + bsv), y3 = bf_hi(uu.y) * (acc[d][3] + bsv);
          u32x2 o; o.x = cvt_pk_bf16(y0, y1); o.y = cvt_pk_bf16(y2, y3); *(u32x2*)(Y + rbase + 16 * d) = o; } }
    LDS_WAIT(); __syncthreads();
}
__device__ __forceinline__ void p2_conv_unit(Frame& F, const Args& A, int l, int q) {
    const int cg = q & 3, st = (q >> 2) & 63, b = q >> 8, s0 = st * 128, rowb = b * SEQ;
    const bf16_t* H = (const bf16_t*)(F.ws + WS_RA + 32 * MiB); bf16_t* Y = (bf16_t*)(F.ws + WS_RC);
    LAS unsigned char* HT = F.lds;
    LAS float* OUT = (LAS float*)(F.lds + 40448) + F.wave * (16 * 132);
    for (int p = F.tid; p < 158 * 16; p += NWAVES * 64) { const int r = p >> 4, c16 = p & 15, s = s0 - 30 + r;
        u32x4 v = (u32x4){0u, 0u, 0u, 0u}; if (s >= 0) v = *(const u32x4*)(H + (size_t)(rowb + s) * 512 + cg * 128 + c16 * 8);
        *(LAS u32x4*)(HT + r * 256 + c16 * 16) = v; }
    LDS_WAIT(); __syncthreads();
    const int cp = F.lane, wv = F.wave;
    float w0[CW], w1[CW];
    { const float* cw = A.in[7] + (size_t)l * CW * 512 + cg * 128 + 2 * cp;
#pragma unroll
      for (int w = 0; w < CW; ++w) { const f32x2 t = *(const f32x2*)(cw + w * 512); w0[w] = t.x; w1[w] = t.y; } }
    float a0[16], a1[16];
    { const f32x2 cb = *(const f32x2*)(A.in[8] + l * 512 + cg * 128 + 2 * cp);
#pragma unroll
      for (int p = 0; p < 16; ++p) { a0[p] = cb.x; a1[p] = cb.y; } }
#pragma unroll
    for (int r = 0; r < 46; ++r) { const unsigned x = *(const LAS unsigned*)(HT + (16 * wv + r) * 256 + cp * 4); const float x0 = bf_lo(x), x1 = bf_hi(x);
#pragma unroll
        for (int p = 0; p < 16; ++p) { if (r - p >= 0 && r - p < CW) { a0[p] += w0[r - p] * x0; a1[p] += w1[r - p] * x1; } } }
#pragma unroll
    for (int p = 0; p < 16; ++p) *(LAS f32x2*)(OUT + p * 132 + 2 * cp) = (f32x2){a0[p], a1[p]};
    LDS_WAIT(); asm volatile("" ::: "memory");
    { const int pos = F.lane >> 2, q4 = F.lane & 3; f32x4 v[8]; float s = 0.f;
#pragma unroll
      for (int k = 0; k < 8; ++k) { v[k] = *(const LAS f32x4*)(OUT + pos * 132 + 32 * q4 + 4 * k); s += (v[k][0] + v[k][1]) + (v[k][2] + v[k][3]); }
      s += __shfl_xor(s, 1); s += __shfl_xor(s, 2);
      const float mean = s * (1.f / 128.f); float q2 = 0.f;
#pragma unroll
      for (int k = 0; k < 8; ++k) { v[k] = v[k] - mean; q2 += (v[k][0] * v[k][0] + v[k][1] * v[k][1]) + (v[k][2] * v[k][2] + v[k][3] * v[k][3]); }
      q2 += __shfl_xor(q2, 1); q2 += __shfl_xor(q2, 2);
      const float rstd = 1.0f / sqrtf(q2 * (1.f / 128.f) + LN_EPS);
      const float* gg = A.in[9] + l * 512 + cg * 128 + 32 * q4; const float* gb = A.in[10] + l * 512 + cg * 128 + 32 * q4;
      bf16_t* yp = Y + (size_t)(rowb + s0 + 16 * wv + pos) * 1024 + 512 + cg * 128 + 32 * q4;
#pragma unroll
      for (int k2 = 0; k2 < 4; ++k2) { float o[8];
#pragma unroll
          for (int j = 0; j < 8; ++j) { const int k = 2 * k2 + (j >> 2); const float t = v[k][j & 3] * rstd * gg[8 * k2 + j] + gb[8 * k2 + j]; o[j] = t * sigmoid_f(t); }
          u32x4 w; w.x = cvt_pk_bf16(o[0], o[1]); w.y = cvt_pk_bf16(o[2], o[3]); w.z = cvt_pk_bf16(o[4], o[5]); w.w = cvt_pk_bf16(o[6], o[7]);
          *(u32x4*)(yp + 8 * k2) = w; } }
    LDS_WAIT(); __syncthreads();
}
__device__ __forceinline__ void p2_mix(Frame& F, const Args& A, int l) {
    for (int q = F.vcu; q < 512; q += F.G) p2_gmlp_unit(F, A, l, q);
    for (int q = F.vcu; q < 512; q += F.G) p2_conv_unit(F, A, l, q);
}

__device__ __forceinline__ void p4_ln_router(Frame& F, const Args& A, int l) {
    const float* PRE = (const float*)(F.ws + WS_RB); bf16_t* X1B = (bf16_t*)(F.ws + WS_RC);
    int* LTOK = (int*)(F.ws + WS_LTOK); float* LGATE = (float*)(F.ws + WS_LGATE);
    LAS float* WrT = (LAS float*)F.lds;
    LAS int* lcnt = (LAS int*)(F.lds + 65536);
    LAS int* rec = (LAS int*)(F.lds + 65536 + 256);
    const float* Wr = A.in[15];
    for (int i = F.tid; i < 1024 * 4; i += NWAVES * 64) { const int d = i >> 2, q = i & 3; const f32x4 w = *(const f32x4*)(Wr + d * 16 + q * 4);
        WrT[(4 * q + 0) * 1024 + d] = w[0]; WrT[(4 * q + 1) * 1024 + d] = w[1]; WrT[(4 * q + 2) * 1024 + d] = w[2]; WrT[(4 * q + 3) * 1024 + d] = w[3]; }
    float rb[16];
#pragma unroll
    for (int e = 0; e < 16; ++e) rb[e] = A.in[16][e];
    f32x4 g1[4], b1[4];
#pragma unroll
    for (int j = 0; j < 4; ++j) { g1[j] = *((const f32x4*)(A.in[13] + l * DM) + F.lane + 64 * j); b1[j] = *((const f32x4*)(A.in[14] + l * DM) + F.lane + 64 * j); }
    for (int blk = F.vcu; blk < M / 64; blk += F.G) {
        if (F.tid < 32) lcnt[F.tid] = 0;
        LDS_WAIT(); __syncthreads();
        for (int i = 0; i < 8; ++i) {
            const int lr = F.wave * 8 + i, row = blk * 64 + lr;
            const f32x4* pr = (const f32x4*)(PRE + (size_t)row * DM) + F.lane;
            f32x4 v[4]; float s = 0.f;
#pragma unroll
            for (int j = 0; j < 4; ++j) { v[j] = pr[64 * j]; s += (v[j][0] + v[j][1]) + (v[j][2] + v[j][3]); }
            const float mean = wave_sum(s) * (1.f / DM); float s2 = 0.f;
#pragma unroll
            for (int j = 0; j < 4; ++j) { v[j] = v[j] - mean; s2 += (v[j][0] * v[j][0] + v[j][1] * v[j][1]) + (v[j][2] * v[j][2] + v[j][3] * v[j][3]); }
            const float rstd = 1.0f / sqrtf(wave_sum(s2) * (1.f / DM) + LN_EPS);
            f32x4* xo = (f32x4*)(F.out + (size_t)row * DM) + F.lane; u32x2* xb = (u32x2*)(X1B + (size_t)row * DM) + F.lane;
#pragma unroll
            for (int j = 0; j < 4; ++j) { v[j] = v[j] * rstd * g1[j] + b1[j]; xo[64 * j] = v[j]; u32x2 w; w.x = cvt_pk_bf16(v[j][0], v[j][1]); w.y = cvt_pk_bf16(v[j][2], v[j][3]); xb[64 * j] = w; }
            float lg[16];
#pragma unroll
            for (int e = 0; e < 16; ++e) { float a = 0.f;
#pragma unroll
                for (int j = 0; j < 4; ++j) { const f32x4 w = *((const LAS f32x4*)(WrT + e * 1024) + F.lane + 64 * j); a += (v[j][0] * w[0] + v[j][1] * w[1]) + (v[j][2] * w[2] + v[j][3] * w[3]); }
                lg[e] = wave_sum(a); }
            float mx = lg[0];
#pragma unroll
            for (int e = 1; e < 16; ++e) mx = fmaxf(mx, lg[e]);
            float sc[16], sum = 0.f;
#pragma unroll
            for (int e = 0; e < 16; ++e) { sc[e] = __expf(lg[e] - mx); sum += sc[e]; }
            const float inv = 1.0f / sum;
#pragma unroll
            for (int e = 0; e < 16; ++e) sc[e] *= inv;
            float best = -INFINITY; int e1 = 0, e2 = 1; float s1 = 0.f, s2v = 0.f;
#pragma unroll
            for (int g = 0; g < 4; ++g) {
                float m1 = sc[4 * g] + rb[4 * g], t1 = sc[4 * g]; int i1 = 0;
#pragma unroll
                for (int j = 1; j < 4; ++j) { const float a = sc[4 * g + j] + rb[4 * g + j]; if (a > m1) { m1 = a; t1 = sc[4 * g + j]; i1 = j; } }
                float m2 = -INFINITY, t2 = 0.f; int i2 = 0;
#pragma unroll
                for (int j = 0; j < 4; ++j) { const float a = sc[4 * g + j] + rb[4 * g + j]; if (j != i1 && a > m2) { m2 = a; t2 = sc[4 * g + j]; i2 = j; } }
                const float gs = m1 + m2;
                if (gs > best) { best = gs; e1 = 4 * g + i1; e2 = 4 * g + i2; s1 = t1; s2v = t2; }
            }
            const float gi = 1.0f / (s1 + s2v);
            if (F.lane == 0) {
                const int p1 = __hip_atomic_fetch_add(lcnt + e1, 1, __ATOMIC_RELAXED, __HIP_MEMORY_SCOPE_WORKGROUP);
                const int p2 = __hip_atomic_fetch_add(lcnt + e2, 1, __ATOMIC_RELAXED, __HIP_MEMORY_SCOPE_WORKGROUP);
                rec[(2 * lr) * 4 + 0] = e1; rec[(2 * lr) * 4 + 1] = p1; rec[(2 * lr) * 4 + 2] = row * 2; rec[(2 * lr) * 4 + 3] = (int)__float_as_uint(s1 * gi);
                rec[(2 * lr + 1) * 4 + 0] = e2; rec[(2 * lr + 1) * 4 + 1] = p2; rec[(2 * lr + 1) * 4 + 2] = row * 2 + 1; rec[(2 * lr + 1) * 4 + 3] = (int)__float_as_uint(s2v * gi);
            }
        }
        LDS_WAIT(); __syncthreads();
        if (F.tid < 16) lcnt[16 + F.tid] = (int)__hip_atomic_fetch_add(F.ctl + CW_CNT + (l * 16 + F.tid) * 64, (unsigned)lcnt[F.tid], RLX_AGENT);
        LDS_WAIT(); __syncthreads();
        if (F.tid < 128) { const int e = rec[F.tid * 4 + 0], p = lcnt[16 + e] + rec[F.tid * 4 + 1];
            LTOK[e * M + p] = rec[F.tid * 4 + 2]; LGATE[e * M + p] = __uint_as_float((unsigned)rec[F.tid * 4 + 3]); }
        LDS_WAIT(); __syncthreads();
    }
}

__device__ __forceinline__ void moe_setup(Frame& F, int l) {
    LAS int* meta = (LAS int*)(F.lds + META_OFF); LAS int* TOK = (LAS int*)(F.lds + TAB_TOK); LAS float* GW = (LAS float*)(F.lds + TAB_GW);
    const int* LTOK = (const int*)(F.ws + WS_LTOK); const float* LGATE = (const float*)(F.ws + WS_LGATE);
    if (F.tid == 0) { int acc = 0;
        for (int e = 0; e < 16; ++e) { const int c = (int)__hip_atomic_load(F.ctl + CW_CNT + (l * 16 + e) * 64, RLX_AGENT); meta[e] = c; meta[16 + e] = acc; acc += (c + 255) >> 8; }
        meta[32] = acc; }
    LDS_WAIT(); __syncthreads();
    const int NT = meta[32]; int nU = 0;
    for (int i = 0; i < 3; ++i) { const int L = i * F.G + F.vcu; if (L >= NT * 4) break;
        const int rt = L >> 2; int e = 0;
        for (int k = 1; k < 16; ++k) e += (meta[16 + k] <= rt) ? 1 : 0;
        const int base = (rt - meta[16 + e]) * 256, left = meta[e] - base;
        if (F.tid == 0) { meta[40 + 4 * i] = rt; meta[41 + 4 * i] = L & 3; meta[42 + 4 * i] = e * 4 + (L & 3); meta[43 + 4 * i] = left < 256 ? left : 256; }
        for (int r = F.tid; r < 256; r += NWAVES * 64) { const bool ok = r < left; const int src = e * M + base + (ok ? r : 0);
            TOK[i * 256 + r] = LTOK[src]; GW[i * 256 + r] = ok ? LGATE[src] : 0.f; }
        ++nU; }
    if (F.tid == 0) meta[36] = nU;
    LDS_WAIT(); __syncthreads();
}

__device__ __forceinline__ void p7_ln2(Frame& F, const Args& A, int l) {
    const bf16_t* YM = (const bf16_t*)(F.ws + WS_RB); bf16_t* XB = (bf16_t*)(F.ws + WS_RC);
    const int gw = F.vcu * NWAVES + F.wave, NGW = F.G * NWAVES;
    f32x4 g2[4], b2[4];
#pragma unroll
    for (int j = 0; j < 4; ++j) { g2[j] = *((const f32x4*)(A.in[20] + l * DM) + F.lane + 64 * j); b2[j] = *((const f32x4*)(A.in[21] + l * DM) + F.lane + 64 * j); }
    for (int row = gw; row < M; row += NGW) {
        f32x4* xr = (f32x4*)(F.out + (size_t)row * DM) + F.lane;
        const u32x2* y0 = (const u32x2*)(YM + (size_t)row * DM) + F.lane; const u32x2* y1 = (const u32x2*)(YM + ((size_t)M + row) * DM) + F.lane;
        f32x4 v[4]; float s = 0.f;
#pragma unroll
        for (int j = 0; j < 4; ++j) { const f32x4 x = xr[64 * j]; const u32x2 a = y0[64 * j], b = y1[64 * j];
            v[j][0] = ALPHA * x[0] + (bf_lo(a.x) + bf_lo(b.x)); v[j][1] = ALPHA * x[1] + (bf_hi(a.x) + bf_hi(b.x));
            v[j][2] = ALPHA * x[2] + (bf_lo(a.y) + bf_lo(b.y)); v[j][3] = ALPHA * x[3] + (bf_hi(a.y) + bf_hi(b.y));
            s += (v[j][0] + v[j][1]) + (v[j][2] + v[j][3]); }
        const float mean = wave_sum(s) * (1.f / DM); float s2 = 0.f;
#pragma unroll
        for (int j = 0; j < 4; ++j) { v[j] = v[j] - mean; s2 += (v[j][0] * v[j][0] + v[j][1] * v[j][1]) + (v[j][2] * v[j][2] + v[j][3] * v[j][3]); }
        const float rstd = 1.0f / sqrtf(wave_sum(s2) * (1.f / DM) + LN_EPS);
        u32x2* xb = (u32x2*)(XB + (size_t)row * DM) + F.lane;
#pragma unroll
        for (int j = 0; j < 4; ++j) { v[j] = v[j] * rstd * g2[j] + b2[j]; xr[64 * j] = v[j]; u32x2 w; w.x = cvt_pk_bf16(v[j][0], v[j][1]); w.y = cvt_pk_bf16(v[j][2], v[j][3]); xb[64 * j] = w; }
    }
}

__global__ void __launch_bounds__(NWAVES * 64, 2) mk_fwd(Args args) {
    extern __shared__ __attribute__((aligned(16))) unsigned char lds[];
    Frame F;
    F.lds = (LAS unsigned char*)lds;
    F.tid = threadIdx.x; F.lane = F.tid & 63; F.wave = __builtin_amdgcn_readfirstlane(F.tid >> 6);
    F.G = gridDim.x; { const int bx = blockIdx.x; F.vcu = (F.G % 8 == 0) ? (bx % 8) * (F.G / 8) + bx / 8 : bx; }
    F.ws = args.ws; F.ctl = (unsigned*)(args.ws + WS_CTL); F.out = args.out;
    volatile LAS unsigned* MISC = (volatile LAS unsigned*)(F.lds + MISC_OFF);
    for (int u = F.tid; u < (LDS_BYTES - TAB_OFF) / 4; u += NWAVES * 64) ((LAS unsigned*)(F.lds + TAB_OFF))[u] = 0u;
    __syncthreads();
    XcdBarrier bar; bar.bar = F.ctl + CW_BAR; bar.x = 0; bar.st = nullptr;
    if (MK_N_LAUNCHES == 1) bar = xcd_barrier_post(F.ctl + CW_BAR, MISC + 8);
    const int lo = args.ph_lo, hi = args.ph_hi;
#ifndef PHMASK
#define PHMASK 0xff
#endif
#define REFRAME() do { int t_ = threadIdx.x; asm volatile("" : "+v"(t_)); F.tid = t_; F.lane = t_ & 63; F.wave = __builtin_amdgcn_readfirstlane(t_ >> 6); } while (0)
#define IN(k) (lo <= (k) && (k) < hi)
#define EN(j) ((PHMASK >> (j)) & 1)
#define SEAM(k) do { if (IN(k) && IN((k) + 1)) xcd_barrier(bar); } while (0)

    if (EN(0) && IN(0)) { REFRAME(); p0_prologue(F, args); } SEAM(0);
    for (int l = 0; l < DEPTH; ++l) {
        const int pb = 1 + 7 * l;
        if (EN(1) && IN(pb + 0)) {
            pg8::Gemm g{(const bf16_t*)(F.ws + WS_RC), (const bf16_t*)(F.ws + WS_WIN) + (size_t)l * DIN * DM, DM};
            pg8::StaticOrder S; S.init(M, DIN, F.G, (int)blockIdx.x);
            pg8::EpiInProj E{(bf16_t*)(F.ws + WS_RA), (bf16_t*)(F.ws + WS_RA + 32 * MiB), (const float*)(F.ws + WS_BIN) + l * DIN};
            pg8::gemm_phase<pg8::EpiInProj, pg8::StaticOrder, true>(F.lds, g, S, E);
        } SEAM(pb + 0);
        if (EN(2) && IN(pb + 1)) { REFRAME(); p2_mix(F, args, l); } SEAM(pb + 1);
        if (EN(3) && IN(pb + 2)) {
            pg8::Gemm g{(const bf16_t*)(F.ws + WS_RC), (const bf16_t*)(F.ws + WS_WOUT) + (size_t)l * DM * DM, DM};
            pg8::StaticOrder S; S.init(M, DM, F.G, (int)blockIdx.x);
            pg8::EpiPre E{(float*)(F.ws + WS_RB), l == 0 ? args.in[0] : (const float*)F.out, args.in[12] + l * DM};
            pg8::gemm_phase<pg8::EpiPre, pg8::StaticOrder, true>(F.lds, g, S, E);
        } SEAM(pb + 2);
        if (EN(4) && IN(pb + 3)) { REFRAME(); p4_ln_router(F, args, l); } SEAM(pb + 3);
        if (EN(5) && IN(pb + 4)) {
            REFRAME(); moe_setup(F, l);
            pg8::Gemm g{(const bf16_t*)(F.ws + WS_RC), (const bf16_t*)(F.ws + WS_WGU) + (size_t)l * NE * 1024 * DM, DM};
            pg8::MoeOrder<true> S{(const LAS int*)(F.lds + META_OFF), (const LAS int*)(F.lds + TAB_TOK)};
            pg8::EpiSwiGLU E{(bf16_t*)(F.ws + WS_RA), (const LAS float*)(F.lds + TAB_GW)};
            pg8::gemm_phase<pg8::EpiSwiGLU, pg8::MoeOrder<true>, true>(F.lds, g, S, E);
        } SEAM(pb + 4);
        if (EN(6) && IN(pb + 5)) {
            REFRAME(); moe_setup(F, l);
            pg8::Gemm g{(const bf16_t*)(F.ws + WS_RA), (const bf16_t*)(F.ws + WS_WD) + (size_t)l * NE * 1024 * DE, DE};
            pg8::MoeOrder<false> S{(const LAS int*)(F.lds + META_OFF), (const LAS int*)(F.lds + TAB_TOK)};
            pg8::EpiScatter E{(bf16_t*)(F.ws + WS_RB), (const LAS int*)(F.lds + TAB_TOK)};
            pg8::gemm_phase<pg8::EpiScatter, pg8::MoeOrder<false>, true>(F.lds, g, S, E);
        } SEAM(pb + 5);
        if (EN(7) && IN(pb + 6)) { REFRAME(); p7_ln2(F, args, l); } SEAM(pb + 6);
    }
#undef IN
#undef SEAM
}

extern "C" void kernel_launch(void* const* d_in, const int* in_sizes, int n_in, void* d_out, int out_size, void* d_ws, size_t ws_size, hipStream_t stream) {
    static int grid = 0;
    if (grid == 0) {
        if (n_in != 22 || out_size != M * DM || ws_size < WS_END) { fprintf(stderr, "kernel_launch: unexpected shapes (n_in %d out %d ws %zu)\n", n_in, out_size, ws_size); grid = -1; return; }
        int dev = 0, cus = 0, per_cu = 0;
        if (hipGetDevice(&dev) != hipSuccess || hipDeviceGetAttribute(&cus, hipDeviceAttributeMultiprocessorCount, dev) != hipSuccess) { grid = -1; return; }
        if (hipFuncSetAttribute((const void*)mk_fwd, hipFuncAttributeMaxDynamicSharedMemorySize, LDS_BYTES) != hipSuccess) { fprintf(stderr, "kernel_launch: hipFuncSetAttribute failed\n"); grid = -1; return; }
        if (hipOccupancyMaxActiveBlocksPerMultiprocessor(&per_cu, (const void*)mk_fwd, NWAVES * 64, LDS_BYTES) != hipSuccess || per_cu < 1) { fprintf(stderr, "kernel_launch: occupancy query says %d blocks per CU\n", per_cu); grid = -1; (void)hipGetLastError(); return; }
        grid = cus;
        if (grid > 256) grid = 256;
    }
    if (grid < 0) return;
    (void)hipMemsetAsync((char*)d_ws + WS_CTL, 0, CTL_ZERO_BYTES, stream);
    Args a{};
    for (int i = 0; i < 22; ++i) a.in[i] = (const float*)d_in[i];
    a.out = (float*)d_out; a.ws = (unsigned char*)d_ws;
    if (MK_N_LAUNCHES == 1) { a.ph_lo = 0; a.ph_hi = N_PHASES; hipLaunchKernelGGL(mk_fwd, dim3(grid), dim3(NWAVES * 64), LDS_BYTES, stream, a); }
    else for (int p = 0; p < N_PHASES; ++p) { a.ph_lo = p; a.ph_hi = p + 1; hipLaunchKernelGGL(mk_fwd, dim3(grid), dim3(NWAVES * 64), LDS_BYTES, stream, a); }
}
```
